# Optimizing an MI355X kernel written in HIP

```python
import math
import jax, jax.numpy as jnp
from jax import lax
import numpy as np

D_MODEL = 1024
BATCH = 16
SEQ = 2048
DEPTH = 2

GRID_W = 64
CTX_LEN = 256
F32 = jnp.float32
EPS = 1e-6
HEAD_DIM = 64
D_MIX = D_MODEL
W_LRU = D_MIX // 4
W_RWKV = D_MIX // 4
W_MLSTM = D_MIX // 4
W_HYENA = D_MIX - W_LRU - W_RWKV - W_MLSTM
GROUP_WIDTHS = (W_LRU, W_RWKV, W_MLSTM, W_HYENA)
H_LRU = W_LRU // HEAD_DIM
H_RWKV = W_RWKV // HEAD_DIM
H_MLSTM = W_MLSTM // HEAD_DIM
CONV_W = 4
LRU_C = 8.0
RWKV_LORA_W = 32
RWKV_LORA_A = 32
RWKV_LORA_G = 64
RWKV_GN_EPS = 64e-5
MLSTM_CHUNK = 64
HYENA_ORDER = 2
HYENA_SHORT = 3
HYENA_EMB = 33
HYENA_HID = 64
HYENA_TARGET = 1e-2
HYENA_FAST = 0.3
HYENA_SLOW = 1.5
PEER_HEADS = 8
PEER_NKEYS = 128
PEER_EXPERTS = PEER_NKEYS * PEER_NKEYS
PEER_TOPK = 16
PEER_DQ = 256
PEER_BLOCK = 128
IN_SPLITS = (W_LRU, W_LRU, W_RWKV, W_RWKV, W_RWKV, RWKV_LORA_W, RWKV_LORA_A, RWKV_LORA_G, W_MLSTM, W_MLSTM, W_MLSTM, W_MLSTM, 4 * H_MLSTM, W_HYENA, W_HYENA, W_HYENA)
D_IN = sum(IN_SPLITS)

kernel_name = 'hybrid_prefix_dit_lru_rwkv_mlstm_hyena_peer'


def rmsnorm(x, g):
    xf = x.astype(F32)
    y = xf * lax.rsqrt(jnp.mean(xf * xf, axis=-1, keepdims=True) + EPS)
    return (y * g.astype(F32)).astype(x.dtype)


def modulate(h, shift, scale):
    return h * (1 + scale) + shift


def flip_if(a, d, axis=1):
    return jnp.flip(a, axis) if d == 1 else a


def split_cols(z):
    offs = np.cumsum(IN_SPLITS)[:-1].tolist()
    return jnp.split(z, offs, axis=-1)


def dwconv(x, w, b, pad_left):
    K = w.shape[0]
    y = lax.conv_general_dilated(x, w[:, None, :].astype(x.dtype), (1,), [(pad_left, K - 1 - pad_left)],
                                 dimension_numbers=('NWC', 'WIO', 'NWC'), feature_group_count=x.shape[-1])
    return y + b.astype(x.dtype)


def token_shift(x, mu):
    prev = jnp.pad(x, ((0, 0), (1, 0), (0, 0)))[:, :-1]
    nxt = jnp.pad(x, ((0, 0), (0, 1), (0, 0)))[:, 1:]
    return x + mu[0] * (prev - x) + mu[1] * (nxt - x)


def split_heads(t, h):
    Bn, L, W = t.shape
    return t.reshape(Bn, L, h, W // h)


def to_colmajor(a):
    Bn, L, C = a.shape
    rows = L // GRID_W
    return a.reshape(Bn, rows, GRID_W, C).transpose(0, 2, 1, 3).reshape(Bn, L, C)


def from_colmajor(a):
    Bn, L, C = a.shape
    rows = L // GRID_W
    return a.reshape(Bn, GRID_W, rows, C).transpose(0, 2, 1, 3).reshape(Bn, L, C)


def linear_recurrence(a, b, h0):
    def comb(l, r):
        return (l[0] * r[0], r[0] * l[1] + r[1])
    A, H = lax.associative_scan(comb, (a, b), axis=1)
    return H + A * h0[:, None, :]


def rglru_scan(xc, p, d, h0):
    Bn, L, W = xc.shape
    xh = xc.reshape(Bn, L, H_LRU, HEAD_DIM)
    r = jax.nn.sigmoid(jnp.einsum('blhi,hij->blhj', xh, p['lru_wr'][d]).reshape(Bn, L, W) + p['lru_br'][d])
    i = jax.nn.sigmoid(jnp.einsum('blhi,hij->blhj', xh, p['lru_wi'][d]).reshape(Bn, L, W) + p['lru_bi'][d])
    log_a = -LRU_C * r * jax.nn.softplus(-p['lru_lam'][d])
    b = jnp.sqrt(-jnp.expm1(2.0 * log_a)) * (i * xc)
    return linear_recurrence(jnp.exp(log_a), b, h0)


def mixer_rglru(f_c, f_l, p, need_ctx):
    (x_c, g_c), (x_l, g_l) = f_c, f_l
    xc_c = dwconv(x_c, p['lru_conv_w'], p['lru_conv_b'], CONV_W // 2).astype(F32)
    xc_l = dwconv(x_l, p['lru_conv_w'], p['lru_conv_b'], CONV_W // 2).astype(F32)
    h0 = jnp.zeros((xc_l.shape[0], W_LRU), F32)
    hs_c, hs_l = [], []
    for d in range(2):
        hc = rglru_scan(flip_if(xc_c, d), p, d, h0)
        hl = rglru_scan(flip_if(xc_l, d), p, d, hc[:, -1])
        hs_c.append(flip_if(hc, d))
        hs_l.append(flip_if(hl, d))
    y_l = jax.nn.gelu(g_l.astype(F32)) * (hs_l[0] + hs_l[1])
    y_c = jax.nn.gelu(g_c.astype(F32)) * (hs_c[0] + hs_c[1]) if need_ctx else None
    return y_c, y_l


def rwkv_shift(f, p):
    r, k, v, zw, za, zg = [t.astype(F32) for t in f]
    mu = p['rwkv_mu']
    return (token_shift(r, mu[0]), token_shift(k, mu[1]), token_shift(v, mu[2]), zw, za, zg)


def rwkv_dir_inputs(f, p, d):
    r, k, v, zw, za, _ = f
    w_log = -jax.nn.softplus(-(p['rwkv_w0'][d] + jnp.tanh(zw) @ p['rwkv_w2'][d])) - 0.5
    decay = jnp.exp(-jnp.exp(w_log))
    a = jax.nn.sigmoid(p['rwkv_a0'][d] + za @ p['rwkv_a2'][d])
    kk = split_heads(k * p['rwkv_kk'], H_RWKV)
    kk = kk / jnp.maximum(jnp.linalg.norm(kk, axis=-1, keepdims=True), 1e-12)
    kd = k * (1 + (a - 1) * p['rwkv_ka'])
    return [split_heads(r, H_RWKV), split_heads(decay, H_RWKV), split_heads(kd, H_RWKV),
            split_heads(v, H_RWKV), kk, kk * split_heads(a, H_RWKV)]


def rwkv7_scan(ins, s0):
    def step(S, inp):
        r, w, k, v, kk, kka = inp
        sa = jnp.einsum('bhvk,bhk->bhv', S, kk)
        S = S * w[:, :, None, :] - sa[..., None] * kka[:, :, None, :] + v[..., None] * k[:, :, None, :]
        return S, jnp.einsum('bhvk,bhk->bhv', S, r)
    S, ys = lax.scan(step, s0, tuple(jnp.moveaxis(t, 1, 0) for t in ins))
    return jnp.moveaxis(ys, 0, 1), S


def rwkv_bonus(ins, p):
    r, _, kd, v = ins[:4]
    return jnp.sum(r * kd * p['rwkv_rk'], axis=-1, keepdims=True) * v


def rwkv_out(y, bonus, zg, p):
    Bn, L, H, N = y.shape
    mu = jnp.mean(y, axis=-1, keepdims=True)
    var = jnp.mean(jnp.square(y - mu), axis=-1, keepdims=True)
    yn = ((y - mu) * lax.rsqrt(var + RWKV_GN_EPS)).reshape(Bn, L, H * N) * p['rwkv_ln_g'] + p['rwkv_ln_b']
    g = jax.nn.sigmoid(zg) @ p['rwkv_g2']
    return (yn + bonus.reshape(Bn, L, H * N)) * g


def mixer_rwkv(f_c, f_l, p, need_ctx):
    fc, fl = rwkv_shift(f_c, p), rwkv_shift(f_l, p)
    s0 = jnp.zeros((fl[0].shape[0], H_RWKV, HEAD_DIM, HEAD_DIM), F32)
    y_c, y_l = [], []
    for d in range(2):
        ic, il = rwkv_dir_inputs(fc, p, d), rwkv_dir_inputs(fl, p, d)
        oc, s_ctx = rwkv7_scan([flip_if(t, d) for t in ic], s0)
        ol, _ = rwkv7_scan([flip_if(t, d) for t in il], s_ctx)
        y_l.append((flip_if(ol, d), rwkv_bonus(il, p)))
        if need_ctx:
            y_c.append((flip_if(oc, d), rwkv_bonus(ic, p)))
    out_l = rwkv_out(y_l[0][0] + y_l[1][0], y_l[0][1] + y_l[1][1], fl[5], p)
    out_c = rwkv_out(y_c[0][0] + y_c[1][0], y_c[0][1] + y_c[1][1], fc[5], p) if need_ctx else None
    return out_c, out_l


def mlstm_prep(f, p):
    q, k, v, o, gz = f
    Bn, L, _ = q.shape
    qk = jax.nn.silu(dwconv(jnp.concatenate([q, k], axis=-1), p['mlstm_conv_w'], p['mlstm_conv_b'], CONV_W // 2)).astype(F32)
    q, k = jnp.split(qk, 2, axis=-1)
    heads = lambda t: t.reshape(Bn, L, H_MLSTM, HEAD_DIM).transpose(0, 2, 1, 3)
    gates = (gz.astype(F32).reshape(Bn, L, 2, 2, H_MLSTM) + p['mlstm_gate_b']).transpose(2, 3, 0, 4, 1)
    return heads(q) * HEAD_DIM ** -0.5, heads(k), heads(v.astype(F32)), o.astype(F32), gates


def mlstm_chunkwise(q, k, v, ig, lf, state):
    Bn, H, L, N = q.shape
    T = MLSTM_CHUNK
    nc = L // T
    ch = lambda a: jnp.moveaxis(a.reshape((Bn, H, nc, T) + a.shape[3:]), 2, 0)
    mask = jnp.tril(jnp.ones((T, T), dtype=bool))

    def step(carry, inp):
        C, n, m = carry
        qc, kc, vc, ic, fc = inp
        b = jnp.cumsum(fc, axis=-1)
        logd = jnp.where(mask, b[..., :, None] - b[..., None, :] + ic[..., None, :], -jnp.inf)
        inter = b + m[..., None]
        mt = jnp.maximum(inter, jnp.max(logd, axis=-1))
        s = jnp.einsum('bhtn,bhsn->bhts', qc, kc) * jnp.exp(logd - mt[..., None])
        e_inter = jnp.exp(inter - mt)
        num = jnp.einsum('bhts,bhsn->bhtn', s, vc) + e_inter[..., None] * jnp.einsum('bhvk,bhtk->bhtv', C, qc)
        den = jnp.sum(s, axis=-1) + e_inter * jnp.einsum('bhk,bhtk->bht', n, qc)
        h = num / jnp.maximum(jnp.abs(den), jnp.exp(-mt))[..., None]
        bT = b[..., -1]
        logw = bT[..., None] - b + ic
        m_new = jnp.maximum(bT + m, jnp.max(logw, axis=-1))
        wgt = jnp.exp(logw - m_new[..., None])
        dec = jnp.exp(bT + m - m_new)
        C = dec[..., None, None] * C + jnp.einsum('bhs,bhsv,bhsk->bhvk', wgt, vc, kc)
        n = dec[..., None] * n + jnp.einsum('bhs,bhsk->bhk', wgt, kc)
        return (C, n, m_new), h

    state, hs = lax.scan(step, state, (ch(q), ch(k), ch(v), ch(ig), ch(lf)))
    return jnp.moveaxis(hs, 0, 2).reshape(Bn, H, L, N), state


def mixer_mlstm(f_c, f_l, p, need_ctx):
    f_l = [to_colmajor(t) for t in f_l]
    qc, kc, vc, oc, gc = mlstm_prep(f_c, p)
    ql, kl, vl, ol, gl = mlstm_prep(f_l, p)
    Bn = ql.shape[0]
    st0 = (jnp.zeros((Bn, H_MLSTM, HEAD_DIM, HEAD_DIM), F32), jnp.zeros((Bn, H_MLSTM, HEAD_DIM), F32),
           jnp.zeros((Bn, H_MLSTM), F32))
    h_c, h_l = [], []
    for d in range(2):
        hc, st = mlstm_chunkwise(flip_if(qc, d, 2), flip_if(kc, d, 2), flip_if(vc, d, 2), flip_if(gc[d, 0], d, 2),
                                 jax.nn.log_sigmoid(flip_if(gc[d, 1], d, 2)), st0)
        hl, _ = mlstm_chunkwise(flip_if(ql, d, 2), flip_if(kl, d, 2), flip_if(vl, d, 2), flip_if(gl[d, 0], d, 2),
                                jax.nn.log_sigmoid(flip_if(gl[d, 1], d, 2)), st)
        h_c.append(flip_if(hc, d, 2))
        h_l.append(flip_if(hl, d, 2))
    merge_heads = lambda h: h.transpose(0, 2, 1, 3).reshape(h.shape[0], h.shape[2], W_MLSTM)
    y_l = from_colmajor(jax.nn.sigmoid(ol) * merge_heads(h_l[0] + h_l[1]))
    y_c = jax.nn.sigmoid(oc) * merge_heads(h_c[0] + h_c[1]) if need_ctx else None
    return y_c, y_l


def hyena_spectrum(L, p):
    pos = jnp.arange(L, dtype=F32)
    t = pos / (L - 1)
    bands = (HYENA_EMB - 1) // 2
    freqs = jnp.linspace(1e-4, bands - 1, bands, dtype=F32)
    ang = (2 * math.pi / L) * pos[:, None] * freqs[None, :]
    z = jnp.concatenate([t[:, None], jnp.cos(ang), -jnp.sin(ang)], axis=-1)
    h = jnp.sin(p['hy_freq'][0] * (z @ p['hy_w1'] + p['hy_b1']))
    h = jnp.sin(p['hy_freq'][1] * (h @ p['hy_w2'] + p['hy_b2']))
    h = (h @ p['hy_w3']).astype(F32).reshape(L, HYENA_ORDER, 2, W_HYENA)
    deltas = jnp.abs(jnp.linspace(math.log(HYENA_TARGET) / HYENA_SLOW, math.log(HYENA_TARGET) / HYENA_FAST,
                                  W_HYENA, dtype=F32))
    h = h * jnp.exp(-t[:, None, None, None] * deltas)
    fwd, bwd = h[:, :, 0], h[:, :, 1]
    two = jnp.concatenate([fwd, jnp.zeros_like(fwd[:1]), jnp.flip(bwd[1:], axis=0)], axis=0)
    two = two / (jnp.sum(jnp.abs(two), axis=0, keepdims=True) + EPS)
    return jnp.fft.rfft(two, axis=0)


def long_conv(u, spec, bias):
    L = u.shape[1]
    y = jnp.fft.irfft(jnp.fft.rfft(u, n=2 * L, axis=1) * spec, n=2 * L, axis=1)[:, :L]
    return y + u * bias


def mixer_hyena(f, p):
    u = dwconv(jnp.concatenate(f, axis=-1), p['hy_conv_w'], p['hy_conv_b'], HYENA_SHORT // 2).astype(F32)
    v, x1, x2 = jnp.split(u, 3, axis=-1)
    spec = hyena_spectrum(u.shape[1], p)
    z = x1 * long_conv(v, spec[:, 0], p['hy_bias'][0])
    return x2 * long_conv(z, spec[:, 1], p['hy_bias'][1])


def peer_ffn(h, p):
    Bn, L, D = h.shape
    wq, keys, u_tab, v_tab = p['peer_wq'], p['peer_keys'].astype(F32), p['peer_u'], p['peer_v']

    def token_block(xb):
        T = xb.shape[0]
        q = (xb @ wq).astype(F32).reshape(T, PEER_HEADS, 2, PEER_DQ // 2)
        s = jnp.einsum('thcq,hckq->thck', q, keys)
        sv, si = lax.top_k(s, PEER_TOPK)
        cand = (sv[:, :, 0, :, None] + sv[:, :, 1, None, :]).reshape(T, PEER_HEADS, PEER_TOPK * PEER_TOPK)
        cidx = (si[:, :, 0, :, None] * PEER_NKEYS + si[:, :, 1, None, :]).reshape(T, PEER_HEADS, PEER_TOPK * PEER_TOPK)
        top_s, top_j = lax.top_k(cand, PEER_TOPK)
        eidx = jnp.take_along_axis(cidx, top_j, axis=-1)
        gate = jax.nn.softmax(top_s, axis=-1)
        act = jax.nn.gelu(jnp.einsum('td,thkd->thk', xb, u_tab[eidx]).astype(F32))
        return jnp.einsum('thk,thkd->td', (gate * act).astype(xb.dtype), v_tab[eidx])

    out = lax.map(token_block, h.reshape(-1, PEER_BLOCK, D))
    return out.reshape(Bn, L, D).astype(h.dtype)


def merge_groups(ys, g, dtype):
    outs, off = [], 0
    for y, w in zip(ys, GROUP_WIDTHS):
        outs.append(rmsnorm(y, g[off:off + w]).astype(dtype))
        off += w
    return jnp.concatenate(outs, axis=-1)


def token_mixers(h_c, h_l, p, need_ctx):
    zc = split_cols(h_c @ p['w_in'])
    zl = split_cols(h_l @ p['w_in'])
    a_c, a_l = mixer_rglru(zc[0:2], zl[0:2], p, need_ctx)
    b_c, b_l = mixer_rwkv(zc[2:8], zl[2:8], p, need_ctx)
    m_c, m_l = mixer_mlstm(zc[8:13], zl[8:13], p, need_ctx)
    d_l = mixer_hyena(zl[13:16], p)
    o_l = merge_groups([a_l, b_l, m_l, d_l], p['grp_g'], h_l.dtype) @ p['w_out']
    if not need_ctx:
        return None, o_l
    d_c = mixer_hyena(zc[13:16], p)
    o_c = merge_groups([a_c, b_c, m_c, d_c], p['grp_g'], h_c.dtype) @ p['w_out']
    return o_c, o_l


def trunk_layer(x_l, x_c, c, c_ctx, p, need_ctx):
    Bn = c.shape[0]
    mod_l = (jax.nn.silu(c) @ p['ada_w'] + p['ada_b']).reshape(Bn, 6, 1, D_MODEL)
    mod_c = (jax.nn.silu(c_ctx) @ p['ada_w'] + p['ada_b']).reshape(6, 1, 1, D_MODEL)
    h_l = modulate(rmsnorm(x_l, p['norm1_g']), mod_l[:, 0], mod_l[:, 1])
    h_c = modulate(rmsnorm(x_c, p['norm1_g']), mod_c[0], mod_c[1])
    o_c, o_l = token_mixers(h_c, h_l, p, need_ctx)
    x_l = x_l + mod_l[:, 2] * o_l
    x_l = x_l + mod_l[:, 5] * peer_ffn(modulate(rmsnorm(x_l, p['norm2_g']), mod_l[:, 3], mod_l[:, 4]), p)
    if need_ctx:
        x_c = x_c + mod_c[2] * o_c
        x_c = x_c + mod_c[5] * peer_ffn(modulate(rmsnorm(x_c, p['norm2_g']), mod_c[3], mod_c[4]), p)
    return x_l, x_c


def setup_inputs(seed: int = 0) -> dict:
    key = jax.random.key(seed)
    ks = iter(jax.random.split(key, 64))

    def nrm(shape, s):
        return s * jax.random.normal(next(ks), shape, F32)

    def gain(shape):
        return 1.0 + nrm(shape, 0.02)

    L_ = DEPTH
    u_lam = jax.random.uniform(next(ks), (L_, 2, W_LRU), F32, 0.9, 0.999)
    s_lam = u_lam ** (1.0 / LRU_C)
    w0 = jnp.linspace(-6.0, -1.0, W_RWKV, dtype=F32) + nrm((L_, 2, W_RWKV), 0.1)
    gate_b = jnp.stack([nrm((L_, 2, H_MLSTM), 0.1),
                        jnp.linspace(3.0, 6.0, H_MLSTM, dtype=F32) + nrm((L_, 2, H_MLSTM), 0.1)], axis=2)
    return dict(
        x=nrm((BATCH, SEQ, D_MODEL), 1.0),
        c=nrm((BATCH, D_MODEL), 1.0),
        ctx=nrm((BATCH, CTX_LEN, D_MODEL), 1.0),
        c_ctx=nrm((D_MODEL,), 1.0),
        ada_w=nrm((L_, D_MODEL, 6 * D_MODEL), 0.5 * D_MODEL ** -0.5),
        ada_b=nrm((L_, 6 * D_MODEL), 0.01),
        norm1_g=gain((L_, D_MODEL)),
        norm2_g=gain((L_, D_MODEL)),
        w_in=nrm((L_, D_MODEL, D_IN), D_MODEL ** -0.5),
        w_out=nrm((L_, D_MIX, D_MODEL), D_MIX ** -0.5),
        grp_g=gain((L_, D_MIX)),
        lru_conv_w=nrm((L_, CONV_W, W_LRU), CONV_W ** -0.5),
        lru_conv_b=nrm((L_, W_LRU), 0.01),
        lru_wr=nrm((L_, 2, H_LRU, HEAD_DIM, HEAD_DIM), HEAD_DIM ** -0.5),
        lru_br=nrm((L_, 2, W_LRU), 0.01),
        lru_wi=nrm((L_, 2, H_LRU, HEAD_DIM, HEAD_DIM), HEAD_DIM ** -0.5),
        lru_bi=nrm((L_, 2, W_LRU), 0.01),
        lru_lam=jnp.log(s_lam) - jnp.log1p(-s_lam),
        rwkv_mu=jax.random.uniform(next(ks), (L_, 3, 2, W_RWKV), F32, 0.0, 0.4),
        rwkv_w0=w0,
        rwkv_w2=nrm((L_, 2, RWKV_LORA_W, W_RWKV), 0.5 * RWKV_LORA_W ** -0.5),
        rwkv_a0=nrm((L_, 2, W_RWKV), 0.1),
        rwkv_a2=nrm((L_, 2, RWKV_LORA_A, W_RWKV), 0.5 * RWKV_LORA_A ** -0.5),
        rwkv_g2=nrm((L_, RWKV_LORA_G, W_RWKV), RWKV_LORA_G ** -0.5),
        rwkv_kk=1.0 + nrm((L_, W_RWKV), 0.1),
        rwkv_ka=1.0 + nrm((L_, W_RWKV), 0.1),
        rwkv_rk=nrm((L_, H_RWKV, HEAD_DIM), 0.1),
        rwkv_ln_g=gain((L_, W_RWKV)),
        rwkv_ln_b=nrm((L_, W_RWKV), 0.01),
        mlstm_conv_w=nrm((L_, CONV_W, 2 * W_MLSTM), CONV_W ** -0.5),
        mlstm_conv_b=nrm((L_, 2 * W_MLSTM), 0.01),
        mlstm_gate_b=gate_b,
        hy_conv_w=nrm((L_, HYENA_SHORT, 3 * W_HYENA), HYENA_SHORT ** -0.5),
        hy_conv_b=nrm((L_, 3 * W_HYENA), 0.01),
        hy_w1=nrm((L_, HYENA_EMB, HYENA_HID), HYENA_EMB ** -0.5),
        hy_b1=nrm((L_, HYENA_HID), 0.01),
        hy_w2=nrm((L_, HYENA_HID, HYENA_HID), HYENA_HID ** -0.5),
        hy_b2=nrm((L_, HYENA_HID), 0.01),
        hy_w3=nrm((L_, HYENA_HID, HYENA_ORDER * 2 * W_HYENA), HYENA_HID ** -0.5),
        hy_freq=1.0 + nrm((L_, 2, HYENA_HID), 0.1),
        hy_bias=nrm((L_, HYENA_ORDER, W_HYENA), 0.1),
        peer_wq=nrm((L_, D_MODEL, PEER_HEADS * PEER_DQ), D_MODEL ** -0.5),
        peer_keys=nrm((L_, PEER_HEADS, 2, PEER_NKEYS, PEER_DQ // 2), (PEER_DQ // 2) ** -0.5),
        peer_u=nrm((L_, PEER_EXPERTS, D_MODEL), D_MODEL ** -0.5),
        peer_v=nrm((L_, PEER_EXPERTS, D_MODEL), PEER_HEADS ** -0.5),
        final_g=gain((D_MODEL,)),
    )


def reference(x, c, ctx, c_ctx, ada_w, ada_b, norm1_g, norm2_g, w_in, w_out, grp_g,
              lru_conv_w, lru_conv_b, lru_wr, lru_br, lru_wi, lru_bi, lru_lam,
              rwkv_mu, rwkv_w0, rwkv_w2, rwkv_a0, rwkv_a2, rwkv_g2, rwkv_kk, rwkv_ka, rwkv_rk, rwkv_ln_g, rwkv_ln_b,
              mlstm_conv_w, mlstm_conv_b, mlstm_gate_b,
              hy_conv_w, hy_conv_b, hy_w1, hy_b1, hy_w2, hy_b2, hy_w3, hy_freq, hy_bias,
              peer_wq, peer_keys, peer_u, peer_v, final_g):
    x_l, x_c = x, ctx
    for i in range(DEPTH):
        p = dict(ada_w=ada_w[i], ada_b=ada_b[i], norm1_g=norm1_g[i], norm2_g=norm2_g[i], w_in=w_in[i],
                 w_out=w_out[i], grp_g=grp_g[i],
                 lru_conv_w=lru_conv_w[i], lru_conv_b=lru_conv_b[i], lru_wr=lru_wr[i], lru_br=lru_br[i],
                 lru_wi=lru_wi[i], lru_bi=lru_bi[i], lru_lam=lru_lam[i],
                 rwkv_mu=rwkv_mu[i], rwkv_w0=rwkv_w0[i], rwkv_w2=rwkv_w2[i], rwkv_a0=rwkv_a0[i],
                 rwkv_a2=rwkv_a2[i], rwkv_g2=rwkv_g2[i], rwkv_kk=rwkv_kk[i], rwkv_ka=rwkv_ka[i],
                 rwkv_rk=rwkv_rk[i], rwkv_ln_g=rwkv_ln_g[i], rwkv_ln_b=rwkv_ln_b[i],
                 mlstm_conv_w=mlstm_conv_w[i], mlstm_conv_b=mlstm_conv_b[i], mlstm_gate_b=mlstm_gate_b[i],
                 hy_conv_w=hy_conv_w[i], hy_conv_b=hy_conv_b[i], hy_w1=hy_w1[i], hy_b1=hy_b1[i],
                 hy_w2=hy_w2[i], hy_b2=hy_b2[i], hy_w3=hy_w3[i], hy_freq=hy_freq[i], hy_bias=hy_bias[i],
                 peer_wq=peer_wq[i], peer_keys=peer_keys[i], peer_u=peer_u[i], peer_v=peer_v[i])
        x_l, x_c = trunk_layer(x_l, x_c, c, c_ctx, p, i < DEPTH - 1)
    return rmsnorm(x_l, final_g)
```

```cpp
#include <hip/hip_runtime.h>
#include <hip/hip_cooperative_groups.h>
#include <cstdio>
#include <cstdint>
#include <cmath>

#ifndef BATCH
#define BATCH 16
#endif
#ifndef SEQ
#define SEQ 2048
#endif
#ifndef CTX_LEN
#define CTX_LEN 256
#endif
#ifndef N_LAUNCH_SPLIT
#define N_LAUNCH_SPLIT 0
#endif

namespace {
typedef unsigned short bf16;
typedef short bf16x8 __attribute__((ext_vector_type(8)));
typedef float f32x4 __attribute__((ext_vector_type(4)));
typedef unsigned u32x4 __attribute__((ext_vector_type(4)));
typedef unsigned u32x2 __attribute__((ext_vector_type(2)));

constexpr int NB = BATCH, LS = SEQ, LC = CTX_LEN;
constexpr int TL = NB * LS, TC = NB * LC, TT = TL + TC;
constexpr int DM = 1024, DIN = 3216, DINP = 3328, NMOD = 6 * DM;
constexpr int GRIDW = 64, GROWS = LS / GRIDW;
constexpr int NTHR = 256;
constexpr int ZC_LRUX = 0, ZC_LRUG = 256, ZC_R = 512, ZC_K = 768, ZC_V = 1024, ZC_LW = 1280, ZC_LA = 1312, ZC_LG = 1344,
              ZC_MQ = 1408, ZC_MK = 1664, ZC_MV = 1920, ZC_MO = 2176, ZC_MG = 2432, ZC_HV = 2448, ZC_HX1 = 2704, ZC_HX2 = 2960;
constexpr int ZC_Y = 0, ZC_Q = 1024;
static_assert(TT % 128 == 0 && TL % 128 == 0, "token count must be a multiple of 128");
static_assert(LS % 64 == 0 && LC % 64 == 0, "sequence lengths must be multiples of 64");

constexpr size_t al256(size_t x) { return (x + 255) & ~(size_t)255; }
constexpr size_t WS_MOD = 0;
constexpr size_t WS_H2B = al256(WS_MOD + sizeof(float) * 2 * (NB + 1) * NMOD);
constexpr size_t WS_HSUM = al256(WS_H2B + sizeof(float) * 2 * (LS + LC) * 64);
constexpr size_t WS_GL = al256(WS_HSUM + 4096);
constexpr size_t WS_GC = al256(WS_GL + 2ull * 2 * 2 * 256 * 2 * LS);
constexpr size_t WS_WIN = al256(WS_GC + 2ull * 2 * 2 * 256 * 2 * LC);
constexpr size_t WS_WOUT = al256(WS_WIN + 2ull * 2 * DINP * DM);
constexpr size_t WS_WQ = al256(WS_WOUT + 2ull * 2 * DM * DM);
constexpr size_t WS_KEYS = al256(WS_WQ + 2ull * 2 * 2048 * DM);
constexpr size_t WS_TABU = al256(WS_KEYS + 2ull * 2 * 8 * 2 * 128 * 128);
constexpr size_t WS_TABV = al256(WS_TABU + 2ull * 16384 * DM);
constexpr size_t WS_XC = al256(WS_TABV + 2ull * 16384 * DM);
constexpr size_t WS_Z = al256(WS_XC + 4ull * TC * DM);
constexpr size_t WS_PART = al256(WS_Z + 2ull * TT * DIN);
constexpr size_t PART_ARR = al256(2ull * TT * 256);
constexpr size_t WS_SB = al256(WS_PART + 9 * PART_ARR);
constexpr size_t WS_END = al256(WS_SB + 4ull * TT * 8);
constexpr size_t WS_H = WS_PART;
constexpr size_t WS_EIDX = WS_PART;
constexpr size_t WS_GATE = al256(WS_EIDX + 4ull * TT * 128);
static_assert(WS_GATE + 4ull * TT * 128 <= WS_SB, "eidx/gate alias overflow");
static_assert(2ull * TT * DM <= 9 * PART_ARR, "h alias overflow");

struct Params {
    const float *x, *c, *ctx, *c_ctx, *ada_w, *ada_b, *norm1_g, *norm2_g, *w_in, *w_out, *grp_g,
        *lru_conv_w, *lru_conv_b, *lru_wr, *lru_br, *lru_wi, *lru_bi, *lru_lam,
        *rwkv_mu, *rwkv_w0, *rwkv_w2, *rwkv_a0, *rwkv_a2, *rwkv_g2, *rwkv_kk, *rwkv_ka, *rwkv_rk, *rwkv_ln_g, *rwkv_ln_b,
        *mlstm_conv_w, *mlstm_conv_b, *mlstm_gate_b,
        *hy_conv_w, *hy_conv_b, *hy_w1, *hy_b1, *hy_w2, *hy_b2, *hy_w3, *hy_freq, *hy_bias,
        *peer_wq, *peer_keys, *peer_u, *peer_v, *final_g;
    float* out; char* ws;
    long long stop_phase;
};

#ifdef EMU
#define FEXP(x) expf(x)
#define WAVE_SYNC() emu::wave_barrier()
#define MFMA16(a, b, c) emu_mfma_16x16x32_bf16(a, b, c)
#define DECL_SMEM char* smem = emu::smem_ptr()
#else
#define FEXP(x) __expf(x)
#define WAVE_SYNC() __builtin_amdgcn_wave_barrier()
#define MFMA16(a, b, c) __builtin_amdgcn_mfma_f32_16x16x32_bf16(a, b, c, 0, 0, 0)
#define DECL_SMEM extern __shared__ __attribute__((aligned(16))) char smem[]
#endif

__device__ __forceinline__ float bf2f(bf16 h) { unsigned u = ((unsigned)h) << 16; float f; __builtin_memcpy(&f, &u, 4); return f; }
__device__ __forceinline__ bf16 f2bf(float f) { unsigned u; __builtin_memcpy(&u, &f, 4); u += 0x7fffu + ((u >> 16) & 1u); return (bf16)(u >> 16); }
__device__ __forceinline__ unsigned pack2(float lo, float hi) { return (unsigned)f2bf(lo) | ((unsigned)f2bf(hi) << 16); }
__device__ __forceinline__ float sigmoidf_(float x) { return 1.f / (1.f + FEXP(-x)); }
__device__ __forceinline__ float siluf_(float x) { return x / (1.f + FEXP(-x)); }
__device__ __forceinline__ float softplusf_(float x) { return x > 20.f ? x : log1pf(FEXP(x)); }
__device__ __forceinline__ float geluf_(float x) { float u = 0.7978845608028654f * (x + 0.044715f * x * x * x); return 0.5f * x * (1.f + tanhf(u)); }
__device__ __forceinline__ float wave_sum(float v) {
#pragma unroll
    for (int m = 32; m >= 1; m >>= 1) v += __shfl_xor(v, m);
    return v;
}
__device__ __forceinline__ float wave_max(float v) {
#pragma unroll
    for (int m = 32; m >= 1; m >>= 1) v = fmaxf(v, __shfl_xor(v, m));
    return v;
}

__device__ __forceinline__ int row_batch(int r) { return r < TL ? r / LS : (r - TL) / LC; }
__device__ __forceinline__ int row_modidx(int r) { return r < TL ? r / LS : NB; }
__device__ __forceinline__ const float* xin_row(const Params& p, int layer, int r) {
    if (r < TL) return (layer == 0 ? p.x : p.out) + (size_t)r * DM;
    return (layer == 0 ? p.ctx : (const float*)(p.ws + WS_XC)) + (size_t)(r - TL) * DM;
}
__device__ __forceinline__ float* xout_row(const Params& p, int r) {
    if (r < TL) return p.out + (size_t)r * DM;
    return (float*)(p.ws + WS_XC) + (size_t)(r - TL) * DM;
}

constexpr int MOD_COLS_PER_ITEM = 256;
constexpr int NMODI = 2 * (NMOD / MOD_COLS_PER_ITEM);
constexpr int TR_TILE = 64;
constexpr int NTR_IN = 2 * (DINP / TR_TILE) * (DM / TR_TILE);
constexpr int NTR_OUT = 2 * (DM / TR_TILE) * (DM / TR_TILE);
constexpr int NTR_WQ = 2 * (2048 / TR_TILE) * (DM / TR_TILE);
constexpr int NKEYI = 2 * 8 * 2 * 128 * 128 / (NTHR * 8);
constexpr int NH2I = 2 * ((LS + LC) / 4);

__device__ __forceinline__ void prep_mod(const Params& p, int item, char* smem) {
    const int layer = item / (NMOD / MOD_COLS_PER_ITEM), cb = item % (NMOD / MOD_COLS_PER_ITEM);
    float* sc = (float*)smem;
    for (int i = threadIdx.x; i < (NB + 1) * DM; i += NTHR) {
        const int r = i / DM, k = i % DM; const float v = r < NB ? p.c[r * DM + k] : p.c_ctx[k];
        sc[i] = siluf_(v);
    }
    __syncthreads();
    const int col = cb * MOD_COLS_PER_ITEM + threadIdx.x;
    float acc[NB + 1];
#pragma unroll
    for (int r = 0; r <= NB; ++r) acc[r] = 0.f;
    const float* w = p.ada_w + (size_t)layer * DM * NMOD + col;
    for (int k = 0; k < DM; ++k) {
        const float wv = w[(size_t)k * NMOD];
#pragma unroll
        for (int r = 0; r <= NB; ++r) acc[r] += sc[r * DM + k] * wv;
    }
    const float bv = p.ada_b[layer * NMOD + col];
    float* mod = (float*)(p.ws + WS_MOD) + (size_t)layer * (NB + 1) * NMOD;
#pragma unroll
    for (int r = 0; r <= NB; ++r) mod[(size_t)r * NMOD + col] = acc[r] + bv;
    __syncthreads();
}

__device__ __forceinline__ void prep_transpose(const float* W, int N, bf16* Wt, int tile, char* smem) {
    float* s = (float*)smem;
    const int ntk = DM / TR_TILE; const int tn = tile / ntk, tk = tile % ntk;
    const int n0 = tn * TR_TILE, k0 = tk * TR_TILE;
    for (int i = threadIdx.x; i < TR_TILE * TR_TILE; i += NTHR) {
        const int kk = i / TR_TILE, nn = i % TR_TILE;
        s[kk * 65 + nn] = (n0 + nn < N) ? W[(size_t)(k0 + kk) * N + n0 + nn] : 0.f;
    }
    __syncthreads();
    for (int i = threadIdx.x; i < TR_TILE * TR_TILE; i += NTHR) {
        const int nn = i / TR_TILE, kk = i % TR_TILE;
        Wt[(size_t)(n0 + nn) * DM + k0 + kk] = f2bf(s[kk * 65 + nn]);
    }
    __syncthreads();
}

__device__ __forceinline__ void prep_h2(const Params& p, int item, char* smem) {
    const int layer = item / ((LS + LC) / 4), pq = item % ((LS + LC) / 4);
    const int sub = threadIdx.x >> 6, j = threadIdx.x & 63;
    const int pg = pq * 4 + sub; const bool lat = pg < LS; const int L = lat ? LS : LC; const int pos = lat ? pg : pg - LS;
    float* zf = (float*)smem + sub * 128;
    const float tt = (float)pos / (float)(L - 1);
    if (j < 33) {
        float v;
        if (j == 0) v = tt;
        else {
            const int bi = (j - 1) & 15; const float fr = 1e-4f + (float)bi * ((15.f - 1e-4f) / 15.f);
            const float ang = (6.283185307179586f / (float)L) * (float)pos * fr;
            v = (j <= 16) ? cosf(ang) : -sinf(ang);
        }
        zf[j] = v;
    }
    __syncthreads();
    float a = p.hy_b1[layer * 64 + j];
    for (int i = 0; i < 33; ++i) a += zf[i] * p.hy_w1[(size_t)layer * 33 * 64 + i * 64 + j];
    zf[64 + j] = sinf(p.hy_freq[layer * 128 + j] * a);
    __syncthreads();
    float b = p.hy_b2[layer * 64 + j];
    for (int i = 0; i < 64; ++i) b += zf[64 + i] * p.hy_w2[(size_t)layer * 64 * 64 + i * 64 + j];
    float* h2 = (float*)(p.ws + WS_H2B) + ((size_t)layer * (LS + LC) + pg) * 64;
    h2[j] = sinf(p.hy_freq[layer * 128 + 64 + j] * b);
    __syncthreads();
}

__device__ __forceinline__ void phase_prep0(const Params& p, char* smem) {
    const int n0 = NMODI, n1 = n0 + NTR_IN, n2 = n1 + NTR_OUT, n3 = n2 + NTR_WQ, n4 = n3 + NKEYI, n5 = n4 + NH2I;
    for (int it = blockIdx.x; it < n5; it += gridDim.x) {
        if (it < n0) prep_mod(p, it, smem);
        else if (it < n1) { const int t = it - n0, per = NTR_IN / 2, layer = t / per;
            prep_transpose(p.w_in + (size_t)layer * DM * DIN, DIN, (bf16*)(p.ws + WS_WIN) + (size_t)layer * DINP * DM, t % per, smem); }
        else if (it < n2) { const int t = it - n1, per = NTR_OUT / 2, layer = t / per;
            prep_transpose(p.w_out + (size_t)layer * DM * DM, DM, (bf16*)(p.ws + WS_WOUT) + (size_t)layer * DM * DM, t % per, smem); }
        else if (it < n3) { const int t = it - n2, per = NTR_WQ / 2, layer = t / per;
            prep_transpose(p.peer_wq + (size_t)layer * DM * 2048, 2048, (bf16*)(p.ws + WS_WQ) + (size_t)layer * 2048 * DM, t % per, smem); }
        else if (it < n4) { const size_t e = ((size_t)(it - n3) * NTHR + threadIdx.x) * 8; bf16* o = (bf16*)(p.ws + WS_KEYS);
#pragma unroll
            for (int i = 0; i < 8; ++i) o[e + i] = f2bf(p.peer_keys[e + i]); }
        else prep_h2(p, it - n4, smem);
    }
}

constexpr int HYF_WG = 4;
constexpr int NHYF_PER = 2 * (256 / HYF_WG);
__device__ __forceinline__ void prep_hyfilter(const Params& p, int item, char* smem) {
    const int layer = item / (2 * NHYF_PER), r0 = item % (2 * NHYF_PER), lsel = r0 / NHYF_PER, r1 = r0 % NHYF_PER;
    const int order = r1 / (256 / HYF_WG), w0 = (r1 % (256 / HYF_WG)) * HYF_WG;
    const int L = lsel == 0 ? LS : LC;
    const float* h2 = (float*)(p.ws + WS_H2B) + ((size_t)layer * (LS + LC) + (lsel == 0 ? 0 : LS)) * 64;
    bf16* G = lsel == 0 ? (bf16*)(p.ws + WS_GL) + ((size_t)(layer * 2 + order) * 256 + w0) * (2 * LS)
                        : (bf16*)(p.ws + WS_GC) + ((size_t)(layer * 2 + order) * 256 + w0) * (2 * LC);
    float* w3s = (float*)smem;
    float* red = w3s + 64 * 2 * HYF_WG;
    float* tot = red + (NTHR / 64) * HYF_WG;
    for (int i = threadIdx.x; i < 64 * 2 * HYF_WG; i += NTHR) {
        const int k = i / (2 * HYF_WG), q = i % (2 * HYF_WG), dirn = q / HYF_WG, w = q % HYF_WG;
        w3s[i] = p.hy_w3[(size_t)layer * 64 * 1024 + (size_t)k * 1024 + order * 512 + dirn * 256 + w0 + w];
    }
    __syncthreads();
    float asum[HYF_WG];
#pragma unroll
    for (int w = 0; w < HYF_WG; ++w) asum[w] = 0.f;
    const float dlo = logf(1e-2f) / 1.5f, dhi = logf(1e-2f) / 0.3f;
    for (int pass = 0; pass < 2; ++pass) {
        float inv[HYF_WG];
        if (pass == 1) {
#pragma unroll
            for (int w = 0; w < HYF_WG; ++w) inv[w] = 1.f / (tot[w] + 1e-6f);
        }
        for (int pos = threadIdx.x; pos < L; pos += NTHR) {
            float acc[2 * HYF_WG];
#pragma unroll
            for (int q = 0; q < 2 * HYF_WG; ++q) acc[q] = 0.f;
            const float* hp = h2 + (size_t)pos * 64;
            for (int k = 0; k < 64; ++k) {
                const float hv = hp[k];
#pragma unroll
                for (int q = 0; q < 2 * HYF_WG; ++q) acc[q] += hv * w3s[k * 2 * HYF_WG + q];
            }
            const float tt = (float)pos / (float)(L - 1);
#pragma unroll
            for (int w = 0; w < HYF_WG; ++w) {
                const float delta = fabsf(dlo + (dhi - dlo) * (float)(w0 + w) / 255.f);
                const float dec = FEXP(-tt * delta);
                const float fw = acc[w] * dec, bw = acc[HYF_WG + w] * dec;
                if (pass == 0) asum[w] += fabsf(fw) + (pos > 0 ? fabsf(bw) : 0.f);
                else {
                    bf16* g = G + (size_t)w * (2 * L);
                    g[L - 1 - pos] = f2bf(fw * inv[w]);
                    if (pos > 0) g[L - 1 + pos] = f2bf(bw * inv[w]);
                    if (pos == 0) g[2 * L - 1] = 0;
                }
            }
        }
        if (pass == 0) {
#pragma unroll
            for (int w = 0; w < HYF_WG; ++w) { const float s = wave_sum(asum[w]); if ((threadIdx.x & 63) == 0) red[(threadIdx.x >> 6) * HYF_WG + w] = s; }
            __syncthreads();
            if (threadIdx.x < HYF_WG) { float s = 0.f; for (int i = 0; i < NTHR / 64; ++i) s += red[i * HYF_WG + threadIdx.x]; tot[threadIdx.x] = s; }
            __syncthreads();
        }
    }
    __syncthreads();
}

__device__ __forceinline__ void convert_tables(const Params& p, int layer, int part, int nparts) {
    const size_t n8 = (size_t)16384 * DM / 8;
    const float* su = p.peer_u + (size_t)layer * 16384 * DM; const float* sv = p.peer_v + (size_t)layer * 16384 * DM;
    bf16* du = (bf16*)(p.ws + WS_TABU); bf16* dv = (bf16*)(p.ws + WS_TABV);
    for (size_t i = (size_t)part * NTHR + threadIdx.x; i < 2 * n8; i += (size_t)nparts * NTHR) {
        const bool isv = i >= n8; const size_t j = isv ? i - n8 : i;
        const float* s = (isv ? sv : su) + j * 8;
        const f32x4 a = *(const f32x4*)s, b = *(const f32x4*)(s + 4);
        u32x4 o; o.x = pack2(a.x, a.y); o.y = pack2(a.z, a.w); o.z = pack2(b.x, b.y); o.w = pack2(b.z, b.w);
        *(u32x4*)((isv ? dv : du) + j * 8) = o;
    }
}

__device__ __forceinline__ void phase_norm(const Params& p, int layer, int which, int nrows) {
    const int lane = threadIdx.x & 63, wv = threadIdx.x >> 6, wpb = NTHR / 64;
    const float* g = (which == 0 ? p.norm1_g : p.norm2_g) + layer * DM;
    const float* mod = (const float*)(p.ws + WS_MOD) + (size_t)layer * (NB + 1) * NMOD;
    for (int r = blockIdx.x * wpb + wv; r < nrows; r += gridDim.x * wpb) {
        const float* xr = which == 0 ? xin_row(p, layer, r) : (const float*)xout_row(p, r);
        float v[16]; float ss = 0.f;
#pragma unroll
        for (int i = 0; i < 4; ++i) { const f32x4 t = *(const f32x4*)(xr + i * 256 + lane * 4); v[4 * i] = t.x; v[4 * i + 1] = t.y; v[4 * i + 2] = t.z; v[4 * i + 3] = t.w; ss += t.x * t.x + t.y * t.y + t.z * t.z + t.w * t.w; }
        ss = wave_sum(ss);
        const float rstd = rsqrtf(ss * (1.f / DM) + 1e-6f);
        const float* mrow = mod + (size_t)row_modidx(r) * NMOD + (which == 0 ? 0 : 3 * DM);
        bf16* o = which == 0 ? (bf16*)(p.ws + WS_H) + (size_t)r * DM : (bf16*)(p.ws + WS_Z) + (size_t)r * DIN + ZC_Y;
#pragma unroll
        for (int i = 0; i < 4; ++i) {
            const int c0 = i * 256 + lane * 4;
            const f32x4 gg = *(const f32x4*)(g + c0), sh = *(const f32x4*)(mrow + c0), sc = *(const f32x4*)(mrow + DM + c0);
            const float y0 = v[4 * i] * rstd * gg.x * (1.f + sc.x) + sh.x, y1 = v[4 * i + 1] * rstd * gg.y * (1.f + sc.y) + sh.y;
            const float y2 = v[4 * i + 2] * rstd * gg.z * (1.f + sc.z) + sh.z, y3 = v[4 * i + 3] * rstd * gg.w * (1.f + sc.w) + sh.w;
            u32x2 w; w.x = pack2(y0, y1); w.y = pack2(y2, y3);
            *(u32x2*)(o + c0) = w;
        }
    }
}

constexpr int GBK = 32, GLD = 40;
template <class Epi>
__device__ __forceinline__ void gemm_tile(const bf16* __restrict__ A, int lda, const bf16* __restrict__ Bt, int ldb, int K, int m0, int n0, const Epi& epi, char* smem) {
    bf16* sA = (bf16*)smem;
    bf16* sB = sA + 2 * 128 * GLD;
    const int tid = threadIdx.x, lane = tid & 63, wv = tid >> 6, wr = wv >> 1, wc = wv & 1;
    const int fr = lane & 15, fq = lane >> 4;
    f32x4 acc[4][4];
#pragma unroll
    for (int i = 0; i < 4; ++i)
#pragma unroll
        for (int j = 0; j < 4; ++j) acc[i][j] = (f32x4){0.f, 0.f, 0.f, 0.f};
    const int lr0 = tid >> 2, lk = (tid & 3) * 8;
    const bf16* ga = A + (size_t)(m0 + lr0) * lda + lk; const bf16* gb = Bt + (size_t)(n0 + lr0) * ldb + lk;
    u32x4 ra0, ra1, rb0, rb1;
    ra0 = *(const u32x4*)ga; ra1 = *(const u32x4*)(ga + (size_t)64 * lda); rb0 = *(const u32x4*)gb; rb1 = *(const u32x4*)(gb + (size_t)64 * ldb);
    const int nk = K / GBK;
    for (int kt = 0; kt < nk; ++kt) {
        bf16* cA = sA + (kt & 1) * 128 * GLD; bf16* cB = sB + (kt & 1) * 128 * GLD;
        *(u32x4*)(cA + lr0 * GLD + lk) = ra0; *(u32x4*)(cA + (lr0 + 64) * GLD + lk) = ra1;
        *(u32x4*)(cB + lr0 * GLD + lk) = rb0; *(u32x4*)(cB + (lr0 + 64) * GLD + lk) = rb1;
        __syncthreads();
        if (kt + 1 < nk) {
            const int ko = (kt + 1) * GBK;
            ra0 = *(const u32x4*)(ga + ko); ra1 = *(const u32x4*)(ga + (size_t)64 * lda + ko);
            rb0 = *(const u32x4*)(gb + ko); rb1 = *(const u32x4*)(gb + (size_t)64 * ldb + ko);
        }
        bf16x8 af[4], bfr[4];
#pragma unroll
        for (int i = 0; i < 4; ++i) af[i] = *(const bf16x8*)(cA + (wr * 64 + i * 16 + fr) * GLD + fq * 8);
#pragma unroll
        for (int j = 0; j < 4; ++j) bfr[j] = *(const bf16x8*)(cB + (wc * 64 + j * 16 + fr) * GLD + fq * 8);
#pragma unroll
        for (int i = 0; i < 4; ++i)
#pragma unroll
            for (int j = 0; j < 4; ++j) acc[i][j] = MFMA16(af[i], bfr[j], acc[i][j]);
    }
    __syncthreads();
#pragma unroll
    for (int i = 0; i < 4; ++i)
#pragma unroll
        for (int j = 0; j < 4; ++j)
#pragma unroll
            for (int r = 0; r < 4; ++r) epi(m0 + wr * 64 + i * 16 + fq * 4 + r, n0 + wc * 64 + j * 16 + fr, acc[i][j][r]);
}

struct EpiZ { bf16* z; __device__ __forceinline__ void operator()(int r, int c, float v) const { if (c < DIN) z[(size_t)r * DIN + c] = f2bf(v); } };

__device__ __forceinline__ void phase_gemm_z(const Params& p, int layer, char* smem) {
    const bf16* A = (const bf16*)(p.ws + WS_H); const bf16* Bt = (const bf16*)(p.ws + WS_WIN) + (size_t)layer * DINP * DM;
    EpiZ epi{(bf16*)(p.ws + WS_Z)};
    constexpr int NTN = DINP / 128, NTM = TT / 128;
    for (int t = blockIdx.x; t < NTM * NTN; t += gridDim.x) {
        const int tm = t / NTN, tn = t % NTN;
        gemm_tile(A, DM, Bt, DM, DM, tm * 128, tn * 128, epi, smem);
    }
}


struct SeqPos { int row, pos, L, base; bool lat; };
__device__ __forceinline__ SeqPos scan_pos(int b, int d, int s) {
    SeqPos q;
    if (s < LC) { q.lat = false; q.L = LC; q.pos = d == 0 ? s : LC - 1 - s; q.base = TL + b * LC; }
    else { q.lat = true; q.L = LS; q.pos = d == 0 ? s - LC : LS - 1 - (s - LC); q.base = b * LS; }
    q.row = q.base + q.pos; return q;
}
__device__ __forceinline__ bf16* part_arr(const Params& p, int i) { return (bf16*)(p.ws + WS_PART + (size_t)i * PART_ARR); }
__device__ __forceinline__ const bf16* zrow(const Params& p, int r) { return (const bf16*)(p.ws + WS_Z) + (size_t)r * DIN; }

__device__ __forceinline__ void mixer_lru(const Params& p, int layer, int item, char* smem) {
    const int b = item / 8, h = (item >> 1) & 3, d = item & 1;
    const int tid = threadIdx.x, j = tid & 63, tq = tid >> 6, c = h * 64 + j;
    float* sx = (float*)smem;
    float* sa = sx + 64 * 64;
    float* sb = sa + 64 * 64;
    const int gsel = tq & 1, th = tq >> 1;
    float wcol[64];
    const float* Wg = (gsel ? p.lru_wi : p.lru_wr) + ((size_t)(layer * 2 + d) * 4 + h) * 64 * 64;
#pragma unroll
    for (int i = 0; i < 64; ++i) wcol[i] = Wg[i * 64 + j];
    const float bg = (gsel ? p.lru_bi : p.lru_br)[(layer * 2 + d) * 256 + c];
    const float spl = 8.f * softplusf_(-p.lru_lam[(layer * 2 + d) * 256 + c]);
    float cw[4];
#pragma unroll
    for (int q = 0; q < 4; ++q) cw[q] = p.lru_conv_w[(layer * 4 + q) * 256 + c];
    const float cb = p.lru_conv_b[layer * 256 + c];
    bf16* outp = part_arr(p, 0 + d);
    float hstate = 0.f;
    for (int s0 = 0; s0 < LC + LS; s0 += 64) {
        for (int n = tq; n < 64; n += 4) {
            const SeqPos q = scan_pos(b, d, s0 + n);
            float acc = cb;
#pragma unroll
            for (int jj = 0; jj < 4; ++jj) { const int pp = q.pos + jj - 2; if (pp >= 0 && pp < q.L) acc += cw[jj] * bf2f(zrow(p, q.base + pp)[ZC_LRUX + c]); }
            sx[n * 64 + j] = acc;
        }
        __syncthreads();
#pragma unroll 1
        for (int n = th; n < 64; n += 2) {
            float ag = bg;
#pragma unroll
            for (int i = 0; i < 64; i += 4) { const f32x4 xv = *(const f32x4*)(sx + n * 64 + i);
                ag += xv.x * wcol[i] + xv.y * wcol[i + 1] + xv.z * wcol[i + 2] + xv.w * wcol[i + 3]; }
            (gsel ? sb : sa)[n * 64 + j] = sigmoidf_(ag);
        }
        __syncthreads();
        for (int n = tq; n < 64; n += 4) {
            const float r = sa[n * 64 + j], ig = sb[n * 64 + j];
            const float log_a = -spl * r;
            sa[n * 64 + j] = FEXP(log_a);
            sb[n * 64 + j] = sqrtf(fmaxf(-expm1f(2.f * log_a), 0.f)) * (ig * sx[n * 64 + j]);
        }
        __syncthreads();
        if (tq == 0) {
#pragma unroll 4
            for (int n = 0; n < 64; ++n) {
                hstate = sa[n * 64 + j] * hstate + sb[n * 64 + j];
                const SeqPos q = scan_pos(b, d, s0 + n);
                outp[(size_t)q.row * 256 + c] = f2bf(hstate);
            }
        }
        __syncthreads();
    }
}

constexpr int RW_CH = 32;
__device__ __forceinline__ void mixer_rwkv(const Params& p, int layer, int item, char* smem) {
    const int b = item / 8, h = (item >> 1) & 3, d = item & 1;
    const int tid = threadIdx.x, k = tid & 63, tq = tid >> 6, c = h * 64 + k;
    float* vec = (float*)smem;
    float* lor = vec + RW_CH * 6 * 64;
    float* ybuf = lor + RW_CH * 64;
    float w2c[32], a2c[32];
#pragma unroll
    for (int i = 0; i < 32; ++i) { w2c[i] = p.rwkv_w2[((size_t)(layer * 2 + d) * 32 + i) * 256 + c]; a2c[i] = p.rwkv_a2[((size_t)(layer * 2 + d) * 32 + i) * 256 + c]; }
    const float w0 = p.rwkv_w0[(layer * 2 + d) * 256 + c], a0 = p.rwkv_a0[(layer * 2 + d) * 256 + c];
    const float kkc = p.rwkv_kk[layer * 256 + c], kac = p.rwkv_ka[layer * 256 + c], rkc = p.rwkv_rk[layer * 256 + c];
    float mu[3][2];
    for (int a = 0; a < 3; ++a) for (int e = 0; e < 2; ++e) mu[a][e] = p.rwkv_mu[((layer * 3 + a) * 2 + e) * 256 + c];
    const int v = tid >> 2, kq = tid & 3;
    float S[16];
#pragma unroll
    for (int i = 0; i < 16; ++i) S[i] = 0.f;
    bf16* outp = part_arr(p, 2 + d);
    float* sbp = (float*)(p.ws + WS_SB);
    for (int s0 = 0; s0 < LC + LS; s0 += RW_CH) {
        for (int i = tid; i < RW_CH * 64; i += NTHR) {
            const int n = i >> 6, jj = i & 63; const SeqPos q = scan_pos(b, d, s0 + n);
            const float zv = bf2f(zrow(p, q.row)[ZC_LW + jj]);
            lor[i] = jj < 32 ? tanhf(zv) : zv;
        }
        __syncthreads();
        for (int n = tq; n < RW_CH; n += 4) {
            const SeqPos q = scan_pos(b, d, s0 + n);
            const bf16* z0 = zrow(p, q.row);
            float cur[3], prv[3], nxt[3];
#pragma unroll
            for (int a = 0; a < 3; ++a) {
                cur[a] = bf2f(z0[ZC_R + a * 256 + c]);
                prv[a] = q.pos > 0 ? bf2f(zrow(p, q.row - 1)[ZC_R + a * 256 + c]) : 0.f;
                nxt[a] = q.pos < q.L - 1 ? bf2f(zrow(p, q.row + 1)[ZC_R + a * 256 + c]) : 0.f;
            }
            const float rs = cur[0] + mu[0][0] * (prv[0] - cur[0]) + mu[0][1] * (nxt[0] - cur[0]);
            const float ks = cur[1] + mu[1][0] * (prv[1] - cur[1]) + mu[1][1] * (nxt[1] - cur[1]);
            const float vs = cur[2] + mu[2][0] * (prv[2] - cur[2]) + mu[2][1] * (nxt[2] - cur[2]);
            float aw = w0, aa = a0;
#pragma unroll
            for (int i = 0; i < 32; i += 4) { const f32x4 t1 = *(const f32x4*)(lor + n * 64 + i), t2 = *(const f32x4*)(lor + n * 64 + 32 + i);
                aw += t1.x * w2c[i] + t1.y * w2c[i + 1] + t1.z * w2c[i + 2] + t1.w * w2c[i + 3];
                aa += t2.x * a2c[i] + t2.y * a2c[i + 1] + t2.z * a2c[i + 2] + t2.w * a2c[i + 3]; }
            const float wlog = -softplusf_(-aw) - 0.5f;
            const float decay = FEXP(-FEXP(wlog));
            const float av = sigmoidf_(aa);
            const float kkr = ks * kkc;
            const float nrm = sqrtf(wave_sum(kkr * kkr));
            const float kkn = kkr / fmaxf(nrm, 1e-12f);
            const float kd = ks * (1.f + (av - 1.f) * kac);
            const float sbv = wave_sum(rs * kd * rkc);
            if (k == 0) sbp[(size_t)q.row * 8 + h * 2 + d] = sbv;
            float* o = vec + n * 6 * 64;
            o[k] = rs; o[64 + k] = decay; o[128 + k] = kd; o[192 + k] = kkn; o[256 + k] = kkn * av; o[320 + k] = vs;
        }
        __syncthreads();
        for (int n = 0; n < RW_CH; ++n) {
            const float* o = vec + n * 6 * 64 + kq * 16;
            float sa = 0.f;
#pragma unroll
            for (int i = 0; i < 16; ++i) sa += S[i] * o[192 + i];
            sa += __shfl_xor(sa, 1); sa += __shfl_xor(sa, 2);
            const float vv = vec[n * 6 * 64 + 320 + v];
            float y = 0.f;
#pragma unroll
            for (int i = 0; i < 16; ++i) { S[i] = S[i] * o[64 + i] - sa * o[256 + i] + vv * o[128 + i]; y += S[i] * o[i]; }
            y += __shfl_xor(y, 1); y += __shfl_xor(y, 2);
            if (kq == 0) ybuf[n * 64 + v] = y;
        }
        __syncthreads();
        for (int i = tid; i < RW_CH * 64; i += NTHR) {
            const int n = i >> 6, vv = i & 63; const SeqPos q = scan_pos(b, d, s0 + n);
            outp[(size_t)q.row * 256 + h * 64 + vv] = f2bf(ybuf[i]);
        }
        __syncthreads();
    }
}

__device__ __forceinline__ int mlstm_row(int b, bool lat, int pos) {
    if (!lat) return TL + b * LC + pos;
    const int col = pos / GROWS, rw = pos % GROWS; return b * LS + rw * GRIDW + col;
}
constexpr int ML_LD = 72;
constexpr int ML_CS = 68;
__device__ __forceinline__ void unpack8f(const bf16* p8, float* f) {
    const u32x4 w = *(const u32x4*)p8;
    f[0] = bf2f((bf16)(w.x & 0xffff)); f[1] = bf2f((bf16)(w.x >> 16)); f[2] = bf2f((bf16)(w.y & 0xffff)); f[3] = bf2f((bf16)(w.y >> 16));
    f[4] = bf2f((bf16)(w.z & 0xffff)); f[5] = bf2f((bf16)(w.z >> 16)); f[6] = bf2f((bf16)(w.w & 0xffff)); f[7] = bf2f((bf16)(w.w >> 16));
}
__device__ __forceinline__ void mixer_mlstm(const Params& p, int layer, int item, char* smem) {
    const int b = item / 8, h = (item >> 1) & 3, d = item & 1;
    const int tid = threadIdx.x, lane = tid & 63;
    bf16* sQ = (bf16*)smem; bf16* sK = sQ + 64 * ML_LD; bf16* sV = sK + 64 * ML_LD;
    float* sS = (float*)(sV + 64 * ML_LD);
    float* sC = sS + 64 * 65;
    float* sn = sC + 64 * ML_CS;
    float* sig = sn + 64; float* sbc = sig + 64; float* smt = sbc + 64; float* sden = smt + 64; float* spm = sden + 64;
    for (int i = tid; i < 64 * ML_CS; i += NTHR) sC[i] = 0.f;
    if (tid < 64) sn[tid] = 0.f;
    float m = 0.f;
    bf16* outp = part_arr(p, 4 + d);
    const float gbi = p.mlstm_gate_b[((layer * 2 + d) * 2 + 0) * 4 + h], gbf = p.mlstm_gate_b[((layer * 2 + d) * 2 + 1) * 4 + h];
    __syncthreads();
    for (int s0 = 0; s0 < LC + LS; s0 += 64) {
        const bool lat = s0 >= LC; const int L = lat ? LS : LC;
        {
            const int n = tid >> 2, cq = (tid & 3) * 16;
            const int sl = s0 + n - (lat ? LC : 0); const int pos = d == 0 ? sl : L - 1 - sl;
            const int row = mlstm_row(b, lat, pos);
#pragma unroll 2
            for (int i = 0; i < 16; ++i) {
                const int ch = h * 64 + cq + i;
                float aq = p.mlstm_conv_b[layer * 512 + ch], ak = p.mlstm_conv_b[layer * 512 + 256 + ch];
#pragma unroll
                for (int jj = 0; jj < 4; ++jj) { const int pp = pos + jj - 2; if (pp >= 0 && pp < L) { const bf16* zr = zrow(p, mlstm_row(b, lat, pp));
                        aq += p.mlstm_conv_w[(layer * 4 + jj) * 512 + ch] * bf2f(zr[ZC_MQ + ch]); ak += p.mlstm_conv_w[(layer * 4 + jj) * 512 + 256 + ch] * bf2f(zr[ZC_MK + ch]); } }
                sQ[n * ML_LD + cq + i] = f2bf(siluf_(aq) * 0.125f); sK[n * ML_LD + cq + i] = f2bf(siluf_(ak));
                sV[n * ML_LD + cq + i] = zrow(p, row)[ZC_MV + ch];
            }
            if ((tid & 3) == 0) {
                const bf16* zr = zrow(p, row);
                sig[n] = bf2f(zr[ZC_MG + d * 8 + h]) + gbi;
                const float fg = bf2f(zr[ZC_MG + d * 8 + 4 + h]) + gbf;
                sbc[n] = -softplusf_(-fg);
            }
        }
        __syncthreads();
        if (tid < 64) {
            float bb = sbc[lane];
#pragma unroll
            for (int o = 1; o < 64; o <<= 1) { const float t = __shfl_up(bb, o); if (lane >= o) bb += t; }
            float g = sig[lane] - bb;
#pragma unroll
            for (int o = 1; o < 64; o <<= 1) { const float t = __shfl_up(g, o); if (lane >= o) g = fmaxf(g, t); }
            sbc[lane] = bb; spm[lane] = g; smt[lane] = bb + fmaxf(m, g);
        }
        __syncthreads();
        {
            const int t = tid >> 2, sq = tid & 3;
            float qr[64];
#pragma unroll
            for (int i = 0; i < 64; i += 8) unpack8f(sQ + t * ML_LD + i, qr + i);
            const float bt = sbc[t], mt = smt[t];
            float rs = 0.f;
#pragma unroll 1
            for (int i = 0; i < 16; ++i) {
                const int s = sq * 16 + i; float val = 0.f;
                if (s <= t) {
                    float dot = 0.f;
#pragma unroll
                    for (int kk = 0; kk < 64; kk += 8) { float kf[8]; unpack8f(sK + s * ML_LD + kk, kf);
#pragma unroll
                        for (int e = 0; e < 8; ++e) dot += qr[kk + e] * kf[e]; }
                    val = dot * FEXP(bt - sbc[s] + sig[s] - mt);
                }
                sS[t * 65 + s] = val; rs += val;
            }
            rs += __shfl_xor(rs, 1); rs += __shfl_xor(rs, 2);
            if (sq == 0) sden[t] = rs;
        }
        __syncthreads();
        {
            const int t = tid >> 2, vq = tid & 3;
            const float mt = smt[t], ei = FEXP(sbc[t] + m - mt);
            float nq = 0.f; float num[16];
#pragma unroll
            for (int i = 0; i < 16; ++i) num[i] = 0.f;
#pragma unroll 2
            for (int kk = 0; kk < 64; ++kk) {
                const float qv = bf2f(sQ[t * ML_LD + kk]);
                nq += sn[kk] * qv;
                const float* cr = sC + kk * ML_CS + vq * 16;
#pragma unroll
                for (int i = 0; i < 16; i += 4) { const f32x4 cv = *(const f32x4*)(cr + i); num[i] += cv.x * qv; num[i + 1] += cv.y * qv; num[i + 2] += cv.z * qv; num[i + 3] += cv.w * qv; }
            }
#pragma unroll
            for (int i = 0; i < 16; ++i) num[i] *= ei;
            const float den = sden[t] + ei * nq; const float dinv = 1.f / fmaxf(fabsf(den), FEXP(-mt));
#pragma unroll 2
            for (int s = 0; s <= t; ++s) { const float sv = sS[t * 65 + s]; float vf[16];
                unpack8f(sV + s * ML_LD + vq * 16, vf); unpack8f(sV + s * ML_LD + vq * 16 + 8, vf + 8);
#pragma unroll
                for (int i = 0; i < 16; ++i) num[i] += sv * vf[i]; }
            const int sl = s0 + t - (lat ? LC : 0); const int pos = d == 0 ? sl : L - 1 - sl;
            bf16* o = outp + (size_t)mlstm_row(b, lat, pos) * 256 + h * 64 + vq * 16;
            u32x4 w0, w1;
            w0.x = pack2(num[0] * dinv, num[1] * dinv); w0.y = pack2(num[2] * dinv, num[3] * dinv); w0.z = pack2(num[4] * dinv, num[5] * dinv); w0.w = pack2(num[6] * dinv, num[7] * dinv);
            w1.x = pack2(num[8] * dinv, num[9] * dinv); w1.y = pack2(num[10] * dinv, num[11] * dinv); w1.z = pack2(num[12] * dinv, num[13] * dinv); w1.w = pack2(num[14] * dinv, num[15] * dinv);
            *(u32x4*)o = w0; *(u32x4*)(o + 8) = w1;
        }
        __syncthreads();
        {
            const float bT = sbc[63]; const float mnew = fmaxf(bT + m, bT + spm[63]); const float dec = FEXP(bT + m - mnew);
            const int v = tid >> 2, kq = tid & 3;
            float acc[16];
#pragma unroll
            for (int i = 0; i < 16; ++i) acc[i] = dec * sC[(kq * 16 + i) * ML_CS + v];
            float nacc = (tid < 64) ? dec * sn[tid] : 0.f;
#pragma unroll 2
            for (int s = 0; s < 64; ++s) {
                const float wg = FEXP(bT - sbc[s] + sig[s] - mnew);
                const float wv = wg * bf2f(sV[s * ML_LD + v]); float kf[16];
                unpack8f(sK + s * ML_LD + kq * 16, kf); unpack8f(sK + s * ML_LD + kq * 16 + 8, kf + 8);
#pragma unroll
                for (int i = 0; i < 16; ++i) acc[i] += wv * kf[i];
                if (tid < 64) nacc += wg * bf2f(sK[s * ML_LD + tid]);
            }
            __syncthreads();
#pragma unroll
            for (int i = 0; i < 16; ++i) sC[(kq * 16 + i) * ML_CS + v] = acc[i];
            if (tid < 64) sn[tid] = nacc;
            m = mnew;
        }
        __syncthreads();
    }
}

__device__ __forceinline__ float hy_shortconv(const Params& p, int layer, int colbase, int c, int base, int pos, int L) {
    float acc = p.hy_conv_b[layer * 768 + colbase + c];
#pragma unroll
    for (int jj = 0; jj < 3; ++jj) { const int pp = pos + jj - 1; if (pp >= 0 && pp < L) acc += p.hy_conv_w[(layer * 3 + jj) * 768 + colbase + c] * bf2f(zrow(p, base + pp)[ZC_HV + colbase + c]); }
    return acc;
}
__device__ __forceinline__ void hyena_pass(const Params& p, int layer, int c, bool lat, int order, const bf16* G, const bf16* srcT, bf16* dstT, char* smem) {
    const int L = lat ? LS : LC; const int tid = threadIdx.x, lane = tid & 63, wv = tid >> 6, fr = lane & 15, fq = lane >> 4;
    const int rowbase0 = lat ? 0 : TL;
    bf16* sG = (bf16*)smem;
    for (int i = tid; i < 2 * L; i += NTHR) sG[i] = G[i];
    __syncthreads();
    const float bias = p.hy_bias[(layer * 2 + order) * 256 + c];
    const int xcol = order == 0 ? 256 : 512;
    const bf16* src = srcT + (size_t)c * TT + rowbase0;
    for (int set = wv; set * 128 < L; set += NTHR / 64) {
        const int ntile = (L - set * 128) / 16 < 8 ? (L - set * 128) / 16 : 8;
        f32x4 acc[8];
#pragma unroll
        for (int i = 0; i < 8; ++i) acc[i] = (f32x4){0.f, 0.f, 0.f, 0.f};
        for (int sk = 0; sk < L; sk += 32) {
            bf16x8 bfrag = (bf16x8){0, 0, 0, 0, 0, 0, 0, 0};
            if (fr < NB) bfrag = *(const bf16x8*)(src + (size_t)fr * L + sk + fq * 8);
#pragma unroll
            for (int i = 0; i < 8; ++i) {
                if (i < ntile) {
                    const int t = set * 128 + i * 16 + fr;
                    const int ib = (L - 1) - t + sk + fq * 8;
                    bf16x8 a;
#pragma unroll
                    for (int jj = 0; jj < 8; ++jj) a[jj] = (short)sG[ib + jj];
                    acc[i] = MFMA16(a, bfrag, acc[i]);
                }
            }
        }
        if (fr < NB) {
#pragma unroll
            for (int i = 0; i < 8; ++i) {
                if (i < ntile) {
#pragma unroll
                    for (int r = 0; r < 4; ++r) {
                        const int t = set * 128 + i * 16 + fq * 4 + r;
                        const int base = rowbase0 + fr * L;
                        const float xk = hy_shortconv(p, layer, xcol, c, base, t, L);
                        const float sv = bf2f(src[(size_t)fr * L + t]);
                        dstT[(size_t)c * TT + base + t] = f2bf(xk * (acc[i][r] + bias * sv));
                    }
                }
            }
        }
    }
    __syncthreads();
}
__device__ __forceinline__ void mixer_hyena(const Params& p, int layer, int item, char* smem) {
    const int c = item & 255; const bool lat = item < 256; const int L = lat ? LS : LC; const int rowbase0 = lat ? 0 : TL;
    bf16* vT = part_arr(p, 6); bf16* z1T = part_arr(p, 7); bf16* oT = part_arr(p, 8);
    for (int i = threadIdx.x; i < NB * L; i += NTHR) {
        const int bb = i / L, t = i % L; const int base = rowbase0 + bb * L;
        vT[(size_t)c * TT + base + t] = f2bf(hy_shortconv(p, layer, 0, c, base, t, L));
    }
    __syncthreads();
    const bf16* G0 = lat ? (const bf16*)(p.ws + WS_GL) + ((size_t)(layer * 2 + 0) * 256 + c) * (2 * LS) : (const bf16*)(p.ws + WS_GC) + ((size_t)(layer * 2 + 0) * 256 + c) * (2 * LC);
    const bf16* G1 = lat ? (const bf16*)(p.ws + WS_GL) + ((size_t)(layer * 2 + 1) * 256 + c) * (2 * LS) : (const bf16*)(p.ws + WS_GC) + ((size_t)(layer * 2 + 1) * 256 + c) * (2 * LC);
    hyena_pass(p, layer, c, lat, 0, G0, vT, z1T, smem);
    hyena_pass(p, layer, c, lat, 1, G1, z1T, oT, smem);
}

__device__ __forceinline__ int first_item(int lo) {
    const int g = (int)gridDim.x, bx = (int)blockIdx.x; const int k = (lo - bx + g - 1) / g; return bx + (k < 0 ? 0 : k) * g;
}
__device__ __forceinline__ void phase_mixers(const Params& p, int layer, char* smem) {
    const int nseq = NB * 8;
    const int nhy = layer == 0 ? 512 : 256;
    const int G = (int)gridDim.x;
    for (int it = first_item(0); it < nseq; it += G) { mixer_rwkv(p, layer, it, smem); __syncthreads(); }
    for (int it = first_item(nseq); it < 2 * nseq; it += G) { mixer_mlstm(p, layer, it - nseq, smem); __syncthreads(); }
    for (int it = first_item(2 * nseq); it < 3 * nseq; it += G) { mixer_lru(p, layer, it - 2 * nseq, smem); __syncthreads(); }
    for (int it = first_item(3 * nseq); it < 3 * nseq + nhy; it += G) { mixer_hyena(p, layer, it - 3 * nseq, smem); __syncthreads(); }
}

__device__ __forceinline__ u32x2 grp_norm(const float (&y)[4], const float* g) {
    const float ss = wave_sum(y[0] * y[0] + y[1] * y[1] + y[2] * y[2] + y[3] * y[3]); const float rstd = rsqrtf(ss * (1.f / 256.f) + 1e-6f);
    const f32x4 gv = *(const f32x4*)g; u32x2 o; o.x = pack2(y[0] * rstd * gv.x, y[1] * rstd * gv.y); o.y = pack2(y[2] * rstd * gv.z, y[3] * rstd * gv.w); return o;
}
__device__ __forceinline__ void phase_finalize(const Params& p, int layer, int nrows, char* smem) {
    const int lane = threadIdx.x & 63, wv = threadIdx.x >> 6, wpb = NTHR / 64;
    float* sg = (float*)smem + wv * 64;
    const float* gg = p.grp_g + layer * DM;
    const int c0 = lane * 4;
    for (int r = blockIdx.x * wpb + wv; r < nrows; r += gridDim.x * wpb) {
        const bf16* z0 = zrow(p, r);
        const bool lat = r < TL; const int L = lat ? LS : LC; const int pos = lat ? r % LS : (r - TL) % LC;
        float ya[4], yb[4], yc[4], yd[4];
        {
            const bf16* f = part_arr(p, 0) + (size_t)r * 256 + c0; const bf16* bk = part_arr(p, 1) + (size_t)r * 256 + c0;
#pragma unroll
            for (int i = 0; i < 4; ++i) ya[i] = geluf_(bf2f(z0[ZC_LRUG + c0 + i])) * (bf2f(f[i]) + bf2f(bk[i]));
        }
        {
            const bf16* f = part_arr(p, 2) + (size_t)r * 256 + c0; const bf16* bk = part_arr(p, 3) + (size_t)r * 256 + c0;
            float ys[4]; float s1 = 0.f;
#pragma unroll
            for (int i = 0; i < 4; ++i) { ys[i] = bf2f(f[i]) + bf2f(bk[i]); s1 += ys[i]; }
#pragma unroll
            for (int m = 8; m >= 1; m >>= 1) s1 += __shfl_xor(s1, m);
            const float mean = s1 * (1.f / 64.f); float s2 = 0.f;
#pragma unroll
            for (int i = 0; i < 4; ++i) { const float dd = ys[i] - mean; s2 += dd * dd; }
#pragma unroll
            for (int m = 8; m >= 1; m >>= 1) s2 += __shfl_xor(s2, m);
            const float rstd = rsqrtf(s2 * (1.f / 64.f) + 64e-5f);
            WAVE_SYNC();
            sg[lane] = sigmoidf_(bf2f(z0[ZC_LG + lane]));
            WAVE_SYNC();
            const int hh = lane >> 4;
            const float* sbp = (const float*)(p.ws + WS_SB) + (size_t)r * 8 + hh * 2;
            const float sbs = sbp[0] + sbp[1];
            float g[4] = {0.f, 0.f, 0.f, 0.f};
            const float* g2 = p.rwkv_g2 + (size_t)layer * 64 * 256 + c0;
#pragma unroll 4
            for (int jj = 0; jj < 64; ++jj) { const float sv = sg[jj]; const f32x4 gv = *(const f32x4*)(g2 + jj * 256); g[0] += sv * gv.x; g[1] += sv * gv.y; g[2] += sv * gv.z; g[3] += sv * gv.w; }
#pragma unroll
            for (int i = 0; i < 4; ++i) {
                const int c = c0 + i;
                const float cur = bf2f(z0[ZC_V + c]);
                const float prv = pos > 0 ? bf2f(zrow(p, r - 1)[ZC_V + c]) : 0.f, nxt = pos < L - 1 ? bf2f(zrow(p, r + 1)[ZC_V + c]) : 0.f;
                const float vs = cur + p.rwkv_mu[((layer * 3 + 2) * 2 + 0) * 256 + c] * (prv - cur) + p.rwkv_mu[((layer * 3 + 2) * 2 + 1) * 256 + c] * (nxt - cur);
                const float yn = (ys[i] - mean) * rstd * p.rwkv_ln_g[layer * 256 + c] + p.rwkv_ln_b[layer * 256 + c];
                yb[i] = (yn + sbs * vs) * g[i];
            }
        }
        {
            const bf16* f = part_arr(p, 4) + (size_t)r * 256 + c0; const bf16* bk = part_arr(p, 5) + (size_t)r * 256 + c0;
#pragma unroll
            for (int i = 0; i < 4; ++i) yc[i] = sigmoidf_(bf2f(z0[ZC_MO + c0 + i])) * (bf2f(f[i]) + bf2f(bk[i]));
        }
        {
            const bf16* o = part_arr(p, 8);
#pragma unroll
            for (int i = 0; i < 4; ++i) yd[i] = bf2f(o[(size_t)(c0 + i) * TT + r]);
        }
        bf16* yo = (bf16*)(p.ws + WS_Z) + (size_t)r * DIN + ZC_Y;
        u32x2 outw[4];
        outw[0] = grp_norm(ya, gg + c0); outw[1] = grp_norm(yb, gg + 256 + c0); outw[2] = grp_norm(yc, gg + 512 + c0); outw[3] = grp_norm(yd, gg + 768 + c0);
#pragma unroll
        for (int gi = 0; gi < 4; ++gi) *(u32x2*)(yo + gi * 256 + c0) = outw[gi];
    }
}

struct EpiRes { const float* xl; const float* xc; float* ol; float* oc; const float* mod;
    __device__ __forceinline__ void operator()(int r, int c, float v) const {
        const float g = mod[(size_t)row_modidx(r) * NMOD + 2 * DM + c];
        if (r < TL) ol[(size_t)r * DM + c] = xl[(size_t)r * DM + c] + g * v;
        else oc[(size_t)(r - TL) * DM + c] = xc[(size_t)(r - TL) * DM + c] + g * v; } };
struct EpiQ { bf16* z; __device__ __forceinline__ void operator()(int r, int c, float v) const { z[(size_t)r * DIN + ZC_Q + c] = f2bf(v); } };

__device__ __forceinline__ void phase_gemm_out(const Params& p, int layer, int nrows, char* smem) {
    const bf16* A = (const bf16*)(p.ws + WS_Z) + ZC_Y; const bf16* Bt = (const bf16*)(p.ws + WS_WOUT) + (size_t)layer * DM * DM;
    EpiRes epi{layer == 0 ? p.x : p.out, layer == 0 ? p.ctx : (const float*)(p.ws + WS_XC), p.out, (float*)(p.ws + WS_XC), (const float*)(p.ws + WS_MOD) + (size_t)layer * (NB + 1) * NMOD};
    const int NTN = DM / 128, NTM = nrows / 128;
    for (int t = blockIdx.x; t < NTM * NTN; t += gridDim.x) gemm_tile(A, DIN, Bt, DM, DM, (t / NTN) * 128, (t % NTN) * 128, epi, smem);
}
__device__ __forceinline__ void phase_gemm_q(const Params& p, int layer, int nrows, char* smem) {
    const bf16* A = (const bf16*)(p.ws + WS_Z) + ZC_Y; const bf16* Bt = (const bf16*)(p.ws + WS_WQ) + (size_t)layer * 2048 * DM;
    EpiQ epi{(bf16*)(p.ws + WS_Z)};
    const int NTN = 2048 / 128, NTM = nrows / 128;
    for (int t = blockIdx.x; t < NTM * NTN; t += gridDim.x) gemm_tile(A, DIN, Bt, DM, DM, (t / NTN) * 128, (t % NTN) * 128, epi, smem);
}

__device__ __forceinline__ void wave_argmax(float& v, int& idx) {
#pragma unroll
    for (int m = 32; m >= 1; m >>= 1) { const float ov = __shfl_xor(v, m); const int oi = __shfl_xor(idx, m); if (ov > v || (ov == v && oi < idx)) { v = ov; idx = oi; } }
}
__device__ __forceinline__ void phase_topk(const Params& p, int layer, int nrows, char* smem) {
    const int lane = threadIdx.x & 63, wv = threadIdx.x >> 6, wpb = NTHR / 64;
    float* sq = (float*)smem + wv * 320;
    float* tv = sq + 256; int* ti = (int*)(tv + 32);
    const bf16* keys = (const bf16*)(p.ws + WS_KEYS) + (size_t)layer * 8 * 2 * 128 * 128;
    int* eidx = (int*)(p.ws + WS_EIDX); float* gate = (float*)(p.ws + WS_GATE);
    const int nwork = nrows * 8;
    for (int w = blockIdx.x * wpb + wv; w < nwork; w += gridDim.x * wpb) {
        const int r = w >> 3, h = w & 7;
        const bf16* q = zrow(p, r) + ZC_Q + h * 256;
        WAVE_SYNC();
        for (int i = lane; i < 256; i += 64) sq[i] = bf2f(q[i]);
        WAVE_SYNC();
        float sc[2][2];
#pragma unroll
        for (int half = 0; half < 2; ++half)
#pragma unroll
            for (int e = 0; e < 2; ++e) {
                const bf16* kr = keys + ((size_t)(h * 2 + half) * 128 + lane + e * 64) * 128;
                float acc = 0.f;
#pragma unroll 4
                for (int i = 0; i < 128; i += 8) { const bf16x8 kv = *(const bf16x8*)(kr + i);
#pragma unroll
                    for (int jj = 0; jj < 8; ++jj) acc += sq[half * 128 + i + jj] * bf2f((bf16)kv[jj]); }
                sc[half][e] = acc;
            }
#pragma unroll
        for (int half = 0; half < 2; ++half) {
            float a0 = sc[half][0], a1 = sc[half][1];
#pragma unroll 1
            for (int k = 0; k < 16; ++k) {
                float bv; int bi;
                if (a0 >= a1) { bv = a0; bi = lane; } else { bv = a1; bi = lane + 64; }
                wave_argmax(bv, bi);
                if (bi == lane) a0 = -INFINITY; if (bi == lane + 64) a1 = -INFINITY;
                if (lane == 0) { tv[half * 16 + k] = bv; ti[half * 16 + k] = bi; }
            }
        }
        WAVE_SYNC();
        float cv[4]; int ci[4];
        { const int i = lane >> 2; const float v0 = tv[i]; const int i0 = ti[i];
#pragma unroll
          for (int m = 0; m < 4; ++m) { const int j = (lane & 3) * 4 + m; cv[m] = v0 + tv[16 + j]; ci[m] = i0 * 128 + ti[16 + j]; } }
        float topv = 0.f; int tope = 0;
#pragma unroll 1
        for (int k = 0; k < 16; ++k) {
            float bv = cv[0]; int bm = 0;
#pragma unroll
            for (int m = 1; m < 4; ++m) if (cv[m] > bv) { bv = cv[m]; bm = m; }
            int bi = lane * 4 + bm;
            wave_argmax(bv, bi);
            const int wl = bi >> 2, wm = bi & 3;
            int e = 0;
#pragma unroll
            for (int m = 0; m < 4; ++m) if (wm == m) e = ci[m];
            e = __shfl(e, wl);
            if (lane == wl) {
#pragma unroll
                for (int m = 0; m < 4; ++m) if (wm == m) cv[m] = -INFINITY;
            }
            if (lane == k) { topv = bv; tope = e; }
        }
        const float mx = __shfl(topv, 0);
        float ex = lane < 16 ? FEXP(topv - mx) : 0.f;
        float sum = ex;
#pragma unroll
        for (int m = 8; m >= 1; m >>= 1) sum += __shfl_xor(sum, m);
        if (lane < 16) { eidx[(size_t)r * 128 + h * 16 + lane] = tope; gate[(size_t)r * 128 + h * 16 + lane] = ex / sum; }
    }
}

__device__ __forceinline__ void unpack8(const u32x4 w, float* f) {
    f[0] = bf2f((bf16)(w.x & 0xffff)); f[1] = bf2f((bf16)(w.x >> 16)); f[2] = bf2f((bf16)(w.y & 0xffff)); f[3] = bf2f((bf16)(w.y >> 16));
    f[4] = bf2f((bf16)(w.z & 0xffff)); f[5] = bf2f((bf16)(w.z >> 16)); f[6] = bf2f((bf16)(w.w & 0xffff)); f[7] = bf2f((bf16)(w.w >> 16));
}
__device__ __forceinline__ void phase_gather(const Params& p, int layer, int nrows) {
    const int lane = threadIdx.x & 63, wv = threadIdx.x >> 6, wpb = NTHR / 64;
    const bf16* tu = (const bf16*)(p.ws + WS_TABU); const bf16* tvv = (const bf16*)(p.ws + WS_TABV);
    const int* eidx = (const int*)(p.ws + WS_EIDX); const float* gate = (const float*)(p.ws + WS_GATE);
    const float* mod = (const float*)(p.ws + WS_MOD) + (size_t)layer * (NB + 1) * NMOD;
    for (int r = blockIdx.x * wpb + wv; r < nrows; r += gridDim.x * wpb) {
        const bf16* hrow = zrow(p, r) + ZC_Y;
        float xr[16];
        unpack8(*(const u32x4*)(hrow + lane * 8), xr); unpack8(*(const u32x4*)(hrow + 512 + lane * 8), xr + 8);
        const int e0 = eidx[(size_t)r * 128 + lane], e1 = eidx[(size_t)r * 128 + 64 + lane];
        const float g0 = gate[(size_t)r * 128 + lane], g1 = gate[(size_t)r * 128 + 64 + lane];
        float acc[16];
#pragma unroll
        for (int i = 0; i < 16; ++i) acc[i] = 0.f;
        for (int k = 0; k < 128; ++k) {
            const int e = __shfl(k < 64 ? e0 : e1, k & 63); const float g = __shfl(k < 64 ? g0 : g1, k & 63);
            const bf16* ur = tu + (size_t)e * DM; const bf16* vr = tvv + (size_t)e * DM;
            float uu[16], vv[16];
            unpack8(*(const u32x4*)(ur + lane * 8), uu); unpack8(*(const u32x4*)(ur + 512 + lane * 8), uu + 8);
            const u32x4 v0 = *(const u32x4*)(vr + lane * 8), v1 = *(const u32x4*)(vr + 512 + lane * 8);
            float dot = 0.f;
#pragma unroll
            for (int i = 0; i < 16; ++i) dot += xr[i] * uu[i];
            dot = wave_sum(dot);
            const float wgt = g * geluf_(dot);
            unpack8(v0, vv); unpack8(v1, vv + 8);
#pragma unroll
            for (int i = 0; i < 16; ++i) acc[i] += wgt * vv[i];
        }
        float* xo = xout_row(p, r); const float* mrow = mod + (size_t)row_modidx(r) * NMOD + 5 * DM;
#pragma unroll
        for (int hf = 0; hf < 2; ++hf) {
            const int cb = hf * 512 + lane * 8;
#pragma unroll
            for (int i = 0; i < 8; i += 4) {
                f32x4 xv = *(f32x4*)(xo + cb + i); const f32x4 mv = *(const f32x4*)(mrow + cb + i);
                xv.x += mv.x * acc[hf * 8 + i]; xv.y += mv.y * acc[hf * 8 + i + 1]; xv.z += mv.z * acc[hf * 8 + i + 2]; xv.w += mv.w * acc[hf * 8 + i + 3];
                *(f32x4*)(xo + cb + i) = xv;
            }
        }
    }
}

__device__ __forceinline__ void phase_final(const Params& p) {
    const int lane = threadIdx.x & 63, wv = threadIdx.x >> 6, wpb = NTHR / 64;
    for (int r = blockIdx.x * wpb + wv; r < TL; r += gridDim.x * wpb) {
        float* xr = p.out + (size_t)r * DM; f32x4 v[4]; float ss = 0.f;
#pragma unroll
        for (int i = 0; i < 4; ++i) { v[i] = *(const f32x4*)(xr + i * 256 + lane * 4); ss += v[i].x * v[i].x + v[i].y * v[i].y + v[i].z * v[i].z + v[i].w * v[i].w; }
        ss = wave_sum(ss); const float rstd = rsqrtf(ss * (1.f / DM) + 1e-6f);
#pragma unroll
        for (int i = 0; i < 4; ++i) { const f32x4 g = *(const f32x4*)(p.final_g + i * 256 + lane * 4); f32x4 o; o.x = v[i].x * rstd * g.x; o.y = v[i].y * rstd * g.y; o.z = v[i].z * rstd * g.z; o.w = v[i].w * rstd * g.w; *(f32x4*)(xr + i * 256 + lane * 4) = o; }
    }
}

constexpr int PH_PER_LAYER = 9;
constexpr int NPHASES = 1 + 2 * PH_PER_LAYER + 1;
constexpr size_t SMEM_BYTES = 72 * 1024;

template <int PH>
__device__ __forceinline__ void run_phase(const Params& p, char* smem) {
    if (PH == 0) { phase_prep0(p, smem); return; }
    if (PH == NPHASES - 1) { phase_final(p); return; }
    constexpr int layer = (PH - 1) / PH_PER_LAYER, sub = (PH - 1) % PH_PER_LAYER;
    constexpr int nrows = layer == 0 ? TT : TL;
    if (sub == 0) {
        if (layer == 0) for (int it = blockIdx.x; it < 4 * NHYF_PER; it += gridDim.x) prep_hyfilter(p, it, smem);
        convert_tables(p, layer, blockIdx.x, gridDim.x);
        phase_norm(p, layer, 0, TT);
    }
    if (sub == 1) phase_gemm_z(p, layer, smem);
    if (sub == 2) phase_mixers(p, layer, smem);
    if (sub == 3) phase_finalize(p, layer, nrows, smem);
    if (sub == 4) phase_gemm_out(p, layer, nrows, smem);
    if (sub == 5) phase_norm(p, layer, 1, nrows);
    if (sub == 6) phase_gemm_q(p, layer, nrows, smem);
    if (sub == 7) phase_topk(p, layer, nrows, smem);
    if (sub == 8) phase_gather(p, layer, nrows);
}
}

namespace cg = cooperative_groups;
__global__ void __launch_bounds__(256, 2) mega(Params p, int ph_begin, int ph_end) {
    DECL_SMEM;
    cg::grid_group grid = cg::this_grid();
    if (ph_end > p.stop_phase) ph_end = (int)p.stop_phase;
#define PH(k) if (k >= ph_begin && k < ph_end) { if (k > ph_begin) grid.sync(); run_phase<k>(p, smem); }
    PH(0) PH(1) PH(2) PH(3) PH(4) PH(5) PH(6) PH(7) PH(8) PH(9) PH(10) PH(11) PH(12) PH(13) PH(14) PH(15) PH(16) PH(17) PH(18) PH(19)
#undef PH
    static_assert(NPHASES == 20, "phase list");
}

extern "C" void kernel_launch(void* const* d_in, const int* in_sizes, int n_in, void* d_out, int out_size, void* d_ws, size_t ws_size, hipStream_t stream) {
    Params p{};
    const float** pf = (const float**)&p;
    for (int i = 0; i < 46; ++i) pf[i] = (const float*)d_in[i];
    p.out = (float*)d_out; p.ws = (char*)d_ws; p.stop_phase = 1000;
#ifdef EMU
    if (getenv("EMU_STOP")) p.stop_phase = atoi(getenv("EMU_STOP"));
    if (ws_size < WS_END) { fprintf(stderr, "ws too small: %zu < %zu\n", ws_size, (size_t)WS_END); abort(); }
    int nblk = getenv("EMU_BLOCKS") ? atoi(getenv("EMU_BLOCKS")) : 4;
    const int b = 0, e = NPHASES;
    emu::launch(dim3(nblk), dim3(NTHR), SMEM_BYTES, [=] { mega(p, b, e); });
#else
    static int grid_blocks = 0;
    if (!grid_blocks) {
        int dev = 0, cus = 0, per_cu = 0;
        hipGetDevice(&dev);
        hipDeviceGetAttribute(&cus, hipDeviceAttributeMultiprocessorCount, dev);
        hipFuncSetAttribute((const void*)mega, hipFuncAttributeMaxDynamicSharedMemorySize, (int)SMEM_BYTES);
        hipOccupancyMaxActiveBlocksPerMultiprocessor(&per_cu, mega, NTHR, SMEM_BYTES);
        if (per_cu > 2) per_cu = 2;
        grid_blocks = cus * per_cu;
    }
    if (ws_size < WS_END) { fprintf(stderr, "ws too small: %zu < %zu\n", ws_size, (size_t)WS_END); return; }
#if N_LAUNCH_SPLIT
    for (int ph = 0; ph < NPHASES; ++ph) {
        int b = ph, e = ph + 1; void* args[] = {&p, &b, &e};
        hipError_t er = hipLaunchCooperativeKernel((void*)mega, dim3(grid_blocks), dim3(NTHR), args, SMEM_BYTES, stream);
        if (er != hipSuccess) fprintf(stderr, "launch failed: %s (grid %d)\n", hipGetErrorString(er), grid_blocks);
    }
#else
    int b = 0, e = NPHASES; void* args[] = {&p, &b, &e};
    hipError_t er = hipLaunchCooperativeKernel((void*)mega, dim3(grid_blocks), dim3(NTHR), args, SMEM_BYTES, stream);
    if (er != hipSuccess) fprintf(stderr, "cooperative launch failed: %s (grid %d)\n", hipGetErrorString(er), grid_blocks);
#endif
#endif
}

#ifdef EMU
#include "emu_dump.inc"
#endif
```
